# Optimizing an MI355X kernel written in HIP

```python
import math
import jax
import jax.numpy as jnp
from jax import lax
import numpy as np

D_MODEL = 1024
BATCH = 4
SEQ = 4096
DEPTH = 1

D_PLE = 256
NSA_HEADS = 8
NSA_GROUPS = 2
NSA_HEAD_DIM = 64
CMP_BLOCK = 32
CMP_STRIDE = 16
CMP_HIDDEN = 256
SLC_BLOCK = 64
SLC_TOPK = 16
SLC_LOCAL = 2
WINDOW = 512
DIFF_HEADS = 4
DIFF_HEAD_DIM = 64
REL_BUCKETS = 32
REL_MAX_EXACT = 16
REL_MAX_DIST = 128
N_BIAS_HEADS = NSA_HEADS + DIFF_HEADS
D_FF = 2816
CONV_WIDTH = 3
Q_BLOCK = 128
ALPHA = (2.0 * DEPTH) ** 0.25
BETA = (8.0 * DEPTH) ** -0.25
LN_EPS = 1e-5
NEG_INF = -1e30
BIG = 1e30

NSA_Q_W = NSA_HEADS * NSA_HEAD_DIM
NSA_KV_W = NSA_GROUPS * NSA_HEAD_DIM
NSA_GATE_W = NSA_HEADS * 3
DIFF_QK_W = DIFF_HEADS * 2 * DIFF_HEAD_DIM
DIFF_V_W = DIFF_HEADS * 2 * DIFF_HEAD_DIM
IN_SIZES = (NSA_Q_W, NSA_KV_W, NSA_KV_W, NSA_KV_W, NSA_KV_W, NSA_KV_W, NSA_KV_W, NSA_GATE_W, DIFF_QK_W, DIFF_QK_W, DIFF_V_W, D_MODEL, D_MODEL)
IN_VALUE_PARTS = (2, 4, 6, 10)
D_IN = sum(IN_SIZES)

kernel_name = 'hybrid_nsa_diffattn_convffn_deepnorm'


def layer_norm(x, g, b):
    xf = x.astype(jnp.float32)
    mu = jnp.mean(xf, axis=-1, keepdims=True)
    xc = xf - mu
    var = jnp.mean(xc * xc, axis=-1, keepdims=True)
    return (xc * lax.rsqrt(var + LN_EPS) * g + b).astype(x.dtype)


def rms_norm(x, g):
    xf = x.astype(jnp.float32)
    return (xf * lax.rsqrt(jnp.mean(xf * xf, axis=-1, keepdims=True) + LN_EPS) * g).astype(x.dtype)


def rel_bucket(dist):
    n = jnp.maximum(dist, 0)
    large = REL_MAX_EXACT + (jnp.log(jnp.maximum(n, 1).astype(jnp.float32) / REL_MAX_EXACT)
                             / math.log(REL_MAX_DIST / REL_MAX_EXACT)
                             * (REL_BUCKETS - REL_MAX_EXACT)).astype(jnp.int32)
    large = jnp.minimum(large, REL_BUCKETS - 1)
    return jnp.where(n < REL_MAX_EXACT, n, large)


def compress_kv(kv, pe, w1, w2):
    B, S, G, Dh = kv.shape
    n_cmp = (S - CMP_BLOCK) // CMP_STRIDE + 1
    idx = np.arange(n_cmp)[:, None] * CMP_STRIDE + np.arange(CMP_BLOCK)[None, :]
    blocks = kv[:, idx] + pe[None, None, :, None, :]
    blocks = blocks.transpose(0, 1, 3, 2, 4).reshape(B, n_cmp, G, CMP_BLOCK * Dh)
    return jax.nn.gelu(blocks @ w1) @ w2


def slc_from_cmp(n_cmp, n_slc):
    ratio = SLC_BLOCK // CMP_STRIDE
    span = CMP_BLOCK // CMP_STRIDE
    j, m, n = np.meshgrid(np.arange(n_slc), np.arange(ratio), np.arange(span), indexing='ij')
    i = ratio * j + m - n
    ok = (i >= 0) & (i < n_cmp)
    mat = np.zeros((n_cmp, n_slc), np.float32)
    np.add.at(mat, (i[ok], j[ok]), 1.0)
    return jnp.asarray(mat)


def nsa_attention(q, k_cmp, v_cmp, k_slc, v_slc, k_win, v_win, gates,
                  pe_k, w1_k, w2_k, pe_v, w1_v, w2_v, table):
    B, S = q.shape[:2]
    G, R, Dh = NSA_GROUPS, NSA_HEADS // NSA_GROUPS, NSA_HEAD_DIM
    scale = Dh ** -0.5
    qg = q.reshape(B, S, G, R, Dh)
    pos = jnp.arange(S)
    tab = table[:, :NSA_HEADS].reshape(REL_BUCKETS, G, R)

    kc = compress_kv(k_cmp, pe_k, w1_k, w2_k)
    vc = compress_kv(v_cmp, pe_v, w1_v, w2_v)
    n_cmp = kc.shape[1]
    blk_end = jnp.arange(n_cmp) * CMP_STRIDE + CMP_BLOCK - 1
    dist_c = pos[:, None] - blk_end[None, :]
    valid_c = dist_c >= 0
    bias_c = jnp.transpose(tab[rel_bucket(dist_c)], (2, 3, 0, 1))
    logit_c = jnp.einsum('bsgrd,bngd->bgrsn', qg, kc).astype(jnp.float32) * scale + bias_c
    logit_c = jnp.where(valid_c, logit_c, NEG_INF)
    p_cmp = jnp.where(valid_c, jax.nn.softmax(logit_c, axis=-1), 0.0)
    o_cmp = jnp.einsum('bgrsn,bngd->bsgrd', p_cmp.astype(vc.dtype), vc)

    n_slc = S // SLC_BLOCK
    p_slc = jnp.einsum('bgrsn,nj->bgsj', p_cmp, slc_from_cmp(n_cmp, n_slc))
    j = jnp.arange(n_slc)[None, :]
    cur = (pos // SLC_BLOCK)[:, None]
    blk_valid = j <= cur
    forced = (j == 0) | ((cur - j >= 0) & (cur - j < SLC_LOCAL))
    score = jnp.where(forced, BIG, jnp.where(blk_valid, p_slc, NEG_INF))
    k_top = min(SLC_TOPK, n_slc)
    _, sel = lax.top_k(score, k_top)

    ks_blocks = k_slc.reshape(B, n_slc, SLC_BLOCK, G, Dh).transpose(0, 3, 1, 2, 4)
    vs_blocks = v_slc.reshape(B, n_slc, SLC_BLOCK, G, Dh).transpose(0, 3, 1, 2, 4)
    pad = ((0, 0), (WINDOW, 0), (0, 0), (0, 0))
    kw_pad = jnp.pad(k_win, pad)
    vw_pad = jnp.pad(v_win, pad)

    nqb = S // Q_BLOCK
    q_blocks = qg.reshape(B, nqb, Q_BLOCK, G, R, Dh).swapaxes(0, 1)
    sel_blocks = sel.reshape(B, G, nqb, Q_BLOCK, k_top).transpose(2, 0, 1, 3, 4)
    b_ix = jnp.arange(B)[:, None, None, None]
    g_ix = jnp.arange(G)[None, :, None, None]
    g_ix5 = jnp.arange(G)[None, :, None, None, None]
    blk_off = jnp.arange(SLC_BLOCK)
    win_off = jnp.arange(WINDOW + Q_BLOCK) - WINDOW

    def block_fn(args):
        qb, selb, ib = args
        q0 = ib * Q_BLOCK
        t = q0 + jnp.arange(Q_BLOCK)
        ks = ks_blocks[b_ix, g_ix, selb]
        vs = vs_blocks[b_ix, g_ix, selb]
        kpos = selb[..., None] * SLC_BLOCK + blk_off
        d_s = t[None, None, :, None, None] - kpos
        b_s = jnp.moveaxis(tab[rel_bucket(d_s), g_ix5], -1, 2)
        s = jnp.einsum('bqgrd,bgqkld->bgrqkl', qb, ks).astype(jnp.float32) * scale + b_s
        s = jnp.where((d_s >= 0)[:, :, None], s, NEG_INF)
        ps = jax.nn.softmax(s.reshape(B, G, R, Q_BLOCK, k_top * SLC_BLOCK), axis=-1)
        ps = ps.reshape(B, G, R, Q_BLOCK, k_top, SLC_BLOCK)
        o_s = jnp.einsum('bgrqkl,bgqkld->bqgrd', ps.astype(vs.dtype), vs)
        kw = lax.dynamic_slice_in_dim(kw_pad, q0, WINDOW + Q_BLOCK, axis=1)
        vw = lax.dynamic_slice_in_dim(vw_pad, q0, WINDOW + Q_BLOCK, axis=1)
        spos = q0 + win_off
        d_w = t[:, None] - spos[None, :]
        valid_w = (d_w >= 0) & (d_w < WINDOW) & (spos[None, :] >= 0)
        b_w = jnp.transpose(tab[rel_bucket(d_w)], (2, 3, 0, 1))
        sw = jnp.einsum('bqgrd,bsgd->bgrqs', qb, kw).astype(jnp.float32) * scale + b_w
        sw = jnp.where(valid_w, sw, NEG_INF)
        pw = jax.nn.softmax(sw, axis=-1)
        o_w = jnp.einsum('bgrqs,bsgd->bqgrd', pw.astype(vw.dtype), vw)
        return o_s, o_w

    o_slc, o_win = lax.map(block_fn, (q_blocks, sel_blocks, jnp.arange(nqb)))
    o_slc = o_slc.swapaxes(0, 1).reshape(B, S, G, R, Dh)
    o_win = o_win.swapaxes(0, 1).reshape(B, S, G, R, Dh)
    g = jax.nn.sigmoid(gates).reshape(B, S, G, R, 3)
    out = g[..., 0:1] * o_cmp + g[..., 1:2] * o_slc + g[..., 2:3] * o_win
    return out.reshape(B, S, NSA_Q_W)


def diff_attention(q, k, v, lq1, lk1, lq2, lk2, subln_g, table, lambda_init):
    B, S = q.shape[:2]
    Hd, d = DIFF_HEADS, DIFF_HEAD_DIM
    scale = d ** -0.5
    q = q.reshape(B, S, Hd, 2, d)
    k = k.reshape(B, S, Hd, 2, d)
    v = v.reshape(B, S, Hd, 2 * d)
    lam = (jnp.exp(jnp.sum(lq1 * lk1).astype(jnp.float32))
           - jnp.exp(jnp.sum(lq2 * lk2).astype(jnp.float32)) + lambda_init)
    tab = table[:, NSA_HEADS:]
    kpos = jnp.arange(S)
    nqb = S // Q_BLOCK
    q_blocks = q.reshape(B, nqb, Q_BLOCK, Hd, 2, d).swapaxes(0, 1)

    def block_fn(args):
        qb, ib = args
        t = ib * Q_BLOCK + jnp.arange(Q_BLOCK)
        dist = t[:, None] - kpos[None, :]
        bias = jnp.transpose(tab[rel_bucket(dist)], (2, 0, 1))[:, None]
        s = jnp.einsum('bqhcd,bshcd->bhcqs', qb, k).astype(jnp.float32) * scale + bias
        s = jnp.where(dist >= 0, s, NEG_INF)
        a = jax.nn.softmax(s, axis=-1)
        attn = a[:, :, 0] - lam * a[:, :, 1]
        return jnp.einsum('bhqs,bshe->bqhe', attn.astype(v.dtype), v)

    o = lax.map(block_fn, (q_blocks, jnp.arange(nqb)))
    o = o.swapaxes(0, 1).reshape(B, S, Hd, 2 * d)
    o = rms_norm(o, subln_g) * (1.0 - lambda_init)
    return o.reshape(B, S, DIFF_V_W)


def causal_dwconv(h, w, b):
    S = h.shape[1]
    hp = jnp.pad(h, ((0, 0), (CONV_WIDTH - 1, 0), (0, 0)))
    out = b
    for kk in range(CONV_WIDTH):
        out = out + w[kk] * hp[:, kk:kk + S]
    return out


def setup_inputs(seed: int = 0) -> dict:
    key = jax.random.key(seed)
    ks = jax.random.split(key, 32)

    def nrm(k, shape, scale):
        return jax.random.normal(k, shape, jnp.float32) * scale

    col_scale = np.concatenate([np.full((s,), BETA if i in IN_VALUE_PARTS else 1.0, np.float32)
                                for i, s in enumerate(IN_SIZES)])
    cmp_in = CMP_BLOCK * NSA_HEAD_DIM
    return {
        'x': nrm(ks[0], (BATCH, SEQ, D_MODEL), 1.0),
        'p': nrm(ks[1], (DEPTH, BATCH, SEQ, D_PLE), 1.0),
        'w_in': nrm(ks[2], (DEPTH, D_MODEL, D_IN), D_MODEL ** -0.5) * jnp.asarray(col_scale),
        'nsa_cmp_pe_k': nrm(ks[3], (DEPTH, CMP_BLOCK, NSA_HEAD_DIM), 0.1),
        'nsa_cmp_w1_k': nrm(ks[4], (DEPTH, cmp_in, CMP_HIDDEN), cmp_in ** -0.5),
        'nsa_cmp_w2_k': nrm(ks[5], (DEPTH, CMP_HIDDEN, NSA_HEAD_DIM), CMP_HIDDEN ** -0.5),
        'nsa_cmp_pe_v': nrm(ks[6], (DEPTH, CMP_BLOCK, NSA_HEAD_DIM), 0.1),
        'nsa_cmp_w1_v': nrm(ks[7], (DEPTH, cmp_in, CMP_HIDDEN), cmp_in ** -0.5),
        'nsa_cmp_w2_v': nrm(ks[8], (DEPTH, CMP_HIDDEN, NSA_HEAD_DIM), CMP_HIDDEN ** -0.5),
        'diff_lambda_q1': nrm(ks[9], (DEPTH, DIFF_HEAD_DIM), 0.1),
        'diff_lambda_k1': nrm(ks[10], (DEPTH, DIFF_HEAD_DIM), 0.1),
        'diff_lambda_q2': nrm(ks[11], (DEPTH, DIFF_HEAD_DIM), 0.1),
        'diff_lambda_k2': nrm(ks[12], (DEPTH, DIFF_HEAD_DIM), 0.1),
        'diff_subln_g': 1.0 + nrm(ks[13], (DEPTH, 2 * DIFF_HEAD_DIM), 0.02),
        'w_branch_nsa': nrm(ks[14], (DEPTH, NSA_Q_W, D_MODEL), NSA_Q_W ** -0.5 * BETA),
        'w_branch_diff': nrm(ks[15], (DEPTH, DIFF_V_W, D_MODEL), DIFF_V_W ** -0.5 * BETA),
        'w_out': nrm(ks[16], (DEPTH, D_MODEL, D_MODEL), D_MODEL ** -0.5 * BETA),
        'ln1_g': 1.0 + nrm(ks[17], (DEPTH, D_MODEL), 0.02),
        'ln1_b': nrm(ks[18], (DEPTH, D_MODEL), 0.02),
        'w_ffn_in': nrm(ks[19], (DEPTH, D_MODEL, 2 * D_FF), D_MODEL ** -0.5),
        'ffn_conv_w': nrm(ks[20], (DEPTH, CONV_WIDTH, D_FF), CONV_WIDTH ** -0.5),
        'ffn_conv_b': nrm(ks[21], (DEPTH, D_FF), 0.02),
        'w_ffn_down': nrm(ks[22], (DEPTH, D_FF, D_MODEL), D_FF ** -0.5 * BETA),
        'ln2_g': 1.0 + nrm(ks[23], (DEPTH, D_MODEL), 0.02),
        'ln2_b': nrm(ks[24], (DEPTH, D_MODEL), 0.02),
        'w_ple_proj': nrm(ks[25], (DEPTH, D_PLE, D_MODEL), D_PLE ** -0.5),
        'w_ple_gate': nrm(ks[26], (DEPTH, D_MODEL, D_MODEL), D_MODEL ** -0.5),
        'rel_bias_table': nrm(ks[27], (REL_BUCKETS, N_BIAS_HEADS), 0.3),
    }


def reference(x, p, w_in, nsa_cmp_pe_k, nsa_cmp_w1_k, nsa_cmp_w2_k, nsa_cmp_pe_v, nsa_cmp_w1_v,
              nsa_cmp_w2_v, diff_lambda_q1, diff_lambda_k1, diff_lambda_q2, diff_lambda_k2,
              diff_subln_g, w_branch_nsa, w_branch_diff, w_out, ln1_g, ln1_b, w_ffn_in,
              ffn_conv_w, ffn_conv_b, w_ffn_down, ln2_g, ln2_b, w_ple_proj, w_ple_gate,
              rel_bias_table):
    B, S, _ = x.shape
    splits = [int(c) for c in np.cumsum(IN_SIZES)[:-1]]
    kv_shape = (B, S, NSA_GROUPS, NSA_HEAD_DIM)
    for l in range(DEPTH):
        lambda_init = 0.8 - 0.6 * math.exp(-0.3 * l)
        proj = x @ w_in[l]
        (nsa_q, k_cmp, v_cmp, k_slc, v_slc, k_win, v_win, nsa_g,
         d_q, d_k, d_v, gate_nsa, gate_diff) = jnp.split(proj, splits, axis=-1)
        y_nsa = nsa_attention(nsa_q, k_cmp.reshape(kv_shape), v_cmp.reshape(kv_shape),
                              k_slc.reshape(kv_shape), v_slc.reshape(kv_shape),
                              k_win.reshape(kv_shape), v_win.reshape(kv_shape), nsa_g,
                              nsa_cmp_pe_k[l], nsa_cmp_w1_k[l], nsa_cmp_w2_k[l],
                              nsa_cmp_pe_v[l], nsa_cmp_w1_v[l], nsa_cmp_w2_v[l], rel_bias_table)
        y_diff = diff_attention(d_q, d_k, d_v, diff_lambda_q1[l], diff_lambda_k1[l],
                                diff_lambda_q2[l], diff_lambda_k2[l], diff_subln_g[l],
                                rel_bias_table, lambda_init)
        merged = (jax.nn.sigmoid(gate_nsa) * (y_nsa @ w_branch_nsa[l])
                  + jax.nn.sigmoid(gate_diff) * (y_diff @ w_branch_diff[l]))
        x = layer_norm(ALPHA * x + merged @ w_out[l], ln1_g[l], ln1_b[l])
        gu = x @ w_ffn_in[l]
        g, u = jnp.split(gu, 2, axis=-1)
        g = causal_dwconv(g, ffn_conv_w[l], ffn_conv_b[l])
        x = layer_norm(ALPHA * x + (jax.nn.gelu(g) * u) @ w_ffn_down[l], ln2_g[l], ln2_b[l])
        x = x + jax.nn.sigmoid(x @ w_ple_gate[l]) * (p[l] @ w_ple_proj[l])
    return x
```

```cpp
#include <hip/hip_runtime.h>
#include <stdint.h>

namespace {
constexpr int BATCH = 4, SEQ = 4096, DM = 1024, M = BATCH * SEQ;
constexpr int DIN = 4888, DFF = 2816, DPLE = 256;
constexpr int NCMP = 255;
constexpr float ALPHA = 1.189207115002721f;
constexpr float LN_EPS = 1e-5f;
constexpr float LAMBDA_INIT = 0.2f;
constexpr int C_NQ = 0, C_KCMP = 512, C_VCMP = 640, C_KSLC = 768, C_VSLC = 896, C_KWIN = 1024, C_VWIN = 1152, C_NG = 1280,
              C_DQ = 1304, C_DK = 1816, C_DV = 2328, C_GN = 2840, C_GD = 3864;

typedef unsigned short bf16_t;
__device__ __forceinline__ float bf2f(bf16_t v) { return __uint_as_float(((unsigned)v) << 16); }
__device__ __forceinline__ bf16_t f2bf(float f) { unsigned u = __float_as_uint(f); return (bf16_t)((u + 0x7fffu + ((u >> 16) & 1u)) >> 16); }
__device__ __forceinline__ float ldf(const float* p) { return *p; }
__device__ __forceinline__ float ldf(const bf16_t* p) { return bf2f(*p); }
__device__ __forceinline__ float sigmoidf_(float v) { return 1.f / (1.f + __expf(-v)); }
__device__ __forceinline__ float gelu_tanh(float v) { const float u = 0.7978845608028654f * (v + 0.044715f * v * v * v); return 0.5f * v * (1.f + tanhf(u)); }
__device__ __forceinline__ int rel_bucket(int dist) {
    int n = dist < 0 ? 0 : dist;
    if (n < 16) return n;
    int large = 16 + (int)(logf((float)n / 16.f) / logf(8.f) * 16.f);
    return large > 31 ? 31 : large;
}

template <typename AT, typename Epi>
__global__ __launch_bounds__(256) void gemm_naive(const AT* __restrict__ A, int lda, const float* __restrict__ B, int ldb, int Mr, int N, int K, Epi epi) {
    __shared__ float As[16][65];
    __shared__ float Bs[16][65];
    const int tid = threadIdx.x, tx = tid & 15, ty = tid >> 4;
    const int m0 = blockIdx.y * 64, n0 = blockIdx.x * 64;
    float acc[4][4];
#pragma unroll
    for (int i = 0; i < 4; ++i)
#pragma unroll
        for (int j = 0; j < 4; ++j) acc[i][j] = 0.f;
    for (int k0 = 0; k0 < K; k0 += 16) {
#pragma unroll
        for (int i = 0; i < 4; ++i) { const int e = tid + i * 256, r = e >> 4, c = e & 15; As[c][r] = ldf(A + (size_t)(m0 + r) * lda + k0 + c); }
#pragma unroll
        for (int i = 0; i < 4; ++i) { const int e = tid + i * 256, r = e >> 6, c = e & 63; Bs[r][c] = (n0 + c < N) ? B[(size_t)(k0 + r) * ldb + n0 + c] : 0.f; }
        __syncthreads();
#pragma unroll
        for (int kk = 0; kk < 16; ++kk) {
            float a[4], b[4];
#pragma unroll
            for (int i = 0; i < 4; ++i) { a[i] = As[kk][ty * 4 + i]; b[i] = Bs[kk][tx * 4 + i]; }
#pragma unroll
            for (int i = 0; i < 4; ++i)
#pragma unroll
                for (int j = 0; j < 4; ++j) acc[i][j] += a[i] * b[j];
        }
        __syncthreads();
    }
#pragma unroll
    for (int i = 0; i < 4; ++i)
#pragma unroll
        for (int j = 0; j < 4; ++j) { const int r = m0 + ty * 4 + i, c = n0 + tx * 4 + j; if (c < N) epi(r, c, acc[i][j]); }
}
struct EpiStoreBf16 { bf16_t* C; int ldc; __device__ void operator()(int r, int c, float v) const { C[(size_t)r * ldc + c] = f2bf(v); } };
struct EpiStoreF32 { float* C; int ldc; __device__ void operator()(int r, int c, float v) const { C[(size_t)r * ldc + c] = v; } };
struct EpiGate { float* C; const bf16_t* proj; int gcol; int accum;
    __device__ void operator()(int r, int c, float v) const { const float g = sigmoidf_(bf2f(proj[(size_t)r * DIN + gcol + c])); float* p = C + (size_t)r * DM + c; *p = (accum ? *p : 0.f) + g * v; } };
struct EpiResid { float* C; const float* base; __device__ void operator()(int r, int c, float v) const { C[(size_t)r * DM + c] = ALPHA * base[(size_t)r * DM + c] + v; } };
struct EpiFinal { float* out; const float* x2; const float* pp; __device__ void operator()(int r, int c, float v) const { const size_t i = (size_t)r * DM + c; out[i] = x2[i] + sigmoidf_(v) * pp[i]; } };

__device__ __forceinline__ float block_sum(float v, float* red) {
    for (int o = 32; o > 0; o >>= 1) v += __shfl_xor(v, o);
    __syncthreads();
    if ((threadIdx.x & 63) == 0) red[threadIdx.x >> 6] = v;
    __syncthreads();
    return red[0] + red[1] + red[2] + red[3];
}
__device__ __forceinline__ float block_max(float v, float* red) {
    for (int o = 32; o > 0; o >>= 1) v = fmaxf(v, __shfl_xor(v, o));
    __syncthreads();
    if ((threadIdx.x & 63) == 0) red[threadIdx.x >> 6] = v;
    __syncthreads();
    return fmaxf(fmaxf(red[0], red[1]), fmaxf(red[2], red[3]));
}

__global__ __launch_bounds__(256) void ln_rows(const float* __restrict__ Z, const float* __restrict__ g, const float* __restrict__ b, float* __restrict__ X) {
    __shared__ float red[4];
    const int r = blockIdx.x, tid = threadIdx.x;
    float v[4]; float s = 0.f;
#pragma unroll
    for (int i = 0; i < 4; ++i) { v[i] = Z[(size_t)r * DM + tid + 256 * i]; s += v[i]; }
    const float mean = block_sum(s, red) * (1.f / DM);
    float q = 0.f;
#pragma unroll
    for (int i = 0; i < 4; ++i) { v[i] -= mean; q += v[i] * v[i]; }
    const float var = block_sum(q, red) * (1.f / DM);
    const float rstd = rsqrtf(var + LN_EPS);
#pragma unroll
    for (int i = 0; i < 4; ++i) { const int c = tid + 256 * i; X[(size_t)r * DM + c] = v[i] * rstd * g[c] + b[c]; }
}

__global__ __launch_bounds__(256) void compress_kernel(const bf16_t* __restrict__ proj, const float* __restrict__ pe_k, const float* __restrict__ w1_k, const float* __restrict__ w2_k,
                                                       const float* __restrict__ pe_v, const float* __restrict__ w1_v, const float* __restrict__ w2_v, float* __restrict__ KC, float* __restrict__ VC) {
    __shared__ float blk[2048];
    __shared__ float hs[256];
    const int c = blockIdx.x, g = blockIdx.y, b = blockIdx.z >> 1, which = blockIdx.z & 1, tid = threadIdx.x;
    const float* pe = which ? pe_v : pe_k; const float* w1 = which ? w1_v : w1_k; const float* w2 = which ? w2_v : w2_k;
    const int col = (which ? C_VCMP : C_KCMP) + g * 64;
    for (int e = tid; e < 2048; e += 256) { const int l = e >> 6, d = e & 63; blk[e] = bf2f(proj[(size_t)(b * SEQ + 16 * c + l) * DIN + col + d]) + pe[e]; }
    __syncthreads();
    float acc = 0.f;
    for (int k = 0; k < 2048; ++k) acc += blk[k] * w1[(size_t)k * 256 + tid];
    hs[tid] = gelu_tanh(acc);
    __syncthreads();
    if (tid < 64) { float o = 0.f; for (int n = 0; n < 256; ++n) o += hs[n] * w2[n * 64 + tid]; (which ? VC : KC)[((size_t)(b * NCMP + c) * 2 + g) * 64 + tid] = o; }
}

__global__ __launch_bounds__(256) void nsa_cmp_kernel(const bf16_t* __restrict__ proj, const float* __restrict__ KC, const float* __restrict__ VC, const float* __restrict__ table,
                                                      float* __restrict__ OC, unsigned long long* __restrict__ SEL) {
    __shared__ float q[4][64];
    __shared__ float p[4][256];
    __shared__ float red[4];
    __shared__ float score[64];
    const int t = blockIdx.x, g = blockIdx.y, b = blockIdx.z, tid = threadIdx.x;
    const size_t row = (size_t)b * SEQ + t;
    q[tid >> 6][tid & 63] = bf2f(proj[row * DIN + C_NQ + g * 256 + tid]);
    __syncthreads();
    const int nvalid = (t >= 31) ? ((t - 31) / 16 + 1 > NCMP ? NCMP : (t - 31) / 16 + 1) : 0;
    float lg[4] = {-1e30f, -1e30f, -1e30f, -1e30f};
    if (tid < nvalid) {
        const float* kc = KC + ((size_t)(b * NCMP + tid) * 2 + g) * 64;
        float a[4] = {0.f, 0.f, 0.f, 0.f};
        for (int d = 0; d < 64; ++d) { const float kv = kc[d]; a[0] += q[0][d] * kv; a[1] += q[1][d] * kv; a[2] += q[2][d] * kv; a[3] += q[3][d] * kv; }
        const int bk = rel_bucket(t - (16 * tid + 31));
#pragma unroll
        for (int r = 0; r < 4; ++r) lg[r] = a[r] * 0.125f + table[bk * 12 + g * 4 + r];
    }
#pragma unroll
    for (int r = 0; r < 4; ++r) {
        const float mx = block_max(lg[r], red);
        const float e = (tid < nvalid) ? __expf(lg[r] - mx) : 0.f;
        const float sm = block_sum(e, red);
        p[r][tid] = (nvalid > 0) ? e / sm : 0.f;
    }
    __syncthreads();
    {
        const int r = tid >> 6, d = tid & 63; float o = 0.f;
        for (int c = 0; c < nvalid; ++c) o += p[r][c] * VC[((size_t)(b * NCMP + c) * 2 + g) * 64 + d];
        OC[row * 512 + (g * 4 + r) * 64 + d] = o;
    }
    if (tid < 64) {
        const int j = tid; float ps = 0.f;
#pragma unroll
        for (int tap = -1; tap <= 3; ++tap) { const int c = 4 * j + tap; if (c >= 0 && c < NCMP) { const float w = (tap == -1 || tap == 3) ? 1.f : 2.f; ps += w * (p[0][c] + p[1][c] + p[2][c] + p[3][c]); } }
        const int cur = t >> 6;
        const bool forced = (j == 0) || (cur - j >= 0 && cur - j < 2);
        const bool valid = j <= cur;
        score[j] = forced ? 1e30f : (valid ? ps : -1e30f);
    }
    __syncthreads();
    if (tid < 64) {
        const float sj = score[tid]; int rank = 0;
        for (int i = 0; i < 64; ++i) { const float si = score[i]; rank += (si > sj || (si == sj && i < tid)) ? 1 : 0; }
        const unsigned long long mask = __ballot(rank < 16);
        if (tid == 0) SEL[row * 2 + g] = mask;
    }
}

__global__ __launch_bounds__(256) void nsa_slc_win_kernel(const bf16_t* __restrict__ proj, const float* __restrict__ OC, const unsigned long long* __restrict__ SEL, const float* __restrict__ table,
                                                          float* __restrict__ Y) {
    __shared__ float q[4][64];
    __shared__ float lg[4][1024];
    __shared__ int kpos_s[1024];
    __shared__ float red[4];
    __shared__ float osl[4][64];
    const int t = blockIdx.x, g = blockIdx.y, b = blockIdx.z, tid = threadIdx.x;
    const size_t row = (size_t)b * SEQ + t;
    q[tid >> 6][tid & 63] = bf2f(proj[row * DIN + C_NQ + g * 256 + tid]);
    const int cur = t >> 6;
    unsigned long long mask = SEL[row * 2 + g];
    mask &= (cur >= 63) ? ~0ull : ((1ull << (cur + 1)) - 1ull);
    const int nsel = __popcll(mask);
    for (int kk = tid; kk < nsel * 64; kk += 256) {
        int n = kk >> 6; unsigned long long mm = mask; for (int i = 0; i < n; ++i) mm &= mm - 1ull;
        const int j = __ffsll((long long)mm) - 1;
        kpos_s[kk] = j * 64 + (kk & 63);
    }
    __syncthreads();
    const int nk = nsel * 64;
    for (int br = 0; br < 2; ++br) {
        const int kcol = (br == 0 ? C_KSLC : C_KWIN) + g * 64, vcol = (br == 0 ? C_VSLC : C_VWIN) + g * 64;
        const int w0 = (t - 511 > 0) ? t - 511 : 0;
        const int cnt = (br == 0) ? nk : (t - w0 + 1);
        float lmax[4] = {-1e30f, -1e30f, -1e30f, -1e30f};
        for (int kk = tid; kk < cnt; kk += 256) {
            const int kp = (br == 0) ? kpos_s[kk] : (w0 + kk);
            if (kp <= t) {
                const bf16_t* kr = proj + ((size_t)b * SEQ + kp) * DIN + kcol;
                float a[4] = {0.f, 0.f, 0.f, 0.f};
                for (int d = 0; d < 64; ++d) { const float kv = bf2f(kr[d]); a[0] += q[0][d] * kv; a[1] += q[1][d] * kv; a[2] += q[2][d] * kv; a[3] += q[3][d] * kv; }
                const int bk = rel_bucket(t - kp);
#pragma unroll
                for (int r = 0; r < 4; ++r) { const float v = a[r] * 0.125f + table[bk * 12 + g * 4 + r]; lg[r][kk] = v; lmax[r] = fmaxf(lmax[r], v); }
            } else {
#pragma unroll
                for (int r = 0; r < 4; ++r) lg[r][kk] = -1e30f;
            }
        }
        float inv[4];
#pragma unroll
        for (int r = 0; r < 4; ++r) {
            const float mx = block_max(lmax[r], red);
            float s = 0.f;
            for (int kk = tid; kk < cnt; kk += 256) { const float v = lg[r][kk]; const float e = (v > -1e29f) ? __expf(v - mx) : 0.f; lg[r][kk] = e; s += e; }
            inv[r] = 1.f / block_sum(s, red);
        }
        __syncthreads();
        const int r = tid >> 6, d = tid & 63; float o = 0.f;
        for (int kk = 0; kk < cnt; ++kk) { const int kp = (br == 0) ? kpos_s[kk] : (w0 + kk); o += lg[r][kk] * bf2f(proj[((size_t)b * SEQ + kp) * DIN + vcol + d]); }
        float invr = (r == 0) ? inv[0] : (r == 1) ? inv[1] : (r == 2) ? inv[2] : inv[3];
        o *= invr;
        if (br == 0) osl[r][d] = o;
        else {
            const int hh = g * 4 + r;
            const float g0 = sigmoidf_(bf2f(proj[row * DIN + C_NG + hh * 3 + 0])), g1 = sigmoidf_(bf2f(proj[row * DIN + C_NG + hh * 3 + 1])), g2 = sigmoidf_(bf2f(proj[row * DIN + C_NG + hh * 3 + 2]));
            Y[row * 1024 + hh * 64 + d] = g0 * OC[row * 512 + hh * 64 + d] + g1 * osl[r][d] + g2 * o;
        }
        __syncthreads();
    }
}

__global__ __launch_bounds__(256) void diff_kernel(const bf16_t* __restrict__ proj, const float* __restrict__ table, const float* __restrict__ lq1, const float* __restrict__ lk1,
                                                   const float* __restrict__ lq2, const float* __restrict__ lk2, const float* __restrict__ subg, float* __restrict__ Y) {
    __shared__ float q[2][64];
    __shared__ float lg[2][4096];
    __shared__ float red[4];
    __shared__ float o1s[128];
    const int t = blockIdx.x, h = blockIdx.y, b = blockIdx.z, tid = threadIdx.x;
    const size_t row = (size_t)b * SEQ + t;
    if (tid < 128) q[tid >> 6][tid & 63] = bf2f(proj[row * DIN + C_DQ + h * 128 + tid]);
    __syncthreads();
    float s1 = 0.f, s2 = 0.f;
    for (int d = 0; d < 64; ++d) { s1 += lq1[d] * lk1[d]; s2 += lq2[d] * lk2[d]; }
    const float lam = __expf(s1) - __expf(s2) + LAMBDA_INIT;
    const int cnt = t + 1;
    float lmax[2] = {-1e30f, -1e30f};
    for (int k = tid; k < cnt; k += 256) {
        const bf16_t* kr = proj + ((size_t)b * SEQ + k) * DIN + C_DK + h * 128;
        float a0 = 0.f, a1 = 0.f;
        for (int d = 0; d < 64; ++d) { a0 += q[0][d] * bf2f(kr[d]); a1 += q[1][d] * bf2f(kr[64 + d]); }
        const float bias = table[rel_bucket(t - k) * 12 + 8 + h];
        a0 = a0 * 0.125f + bias; a1 = a1 * 0.125f + bias;
        lg[0][k] = a0; lg[1][k] = a1; lmax[0] = fmaxf(lmax[0], a0); lmax[1] = fmaxf(lmax[1], a1);
    }
    float inv[2];
#pragma unroll
    for (int c = 0; c < 2; ++c) {
        const float mx = block_max(lmax[c], red);
        float s = 0.f;
        for (int k = tid; k < cnt; k += 256) { const float e = __expf(lg[c][k] - mx); lg[c][k] = e; s += e; }
        inv[c] = 1.f / block_sum(s, red);
    }
    __syncthreads();
    const int c = tid >> 7, e = tid & 127;
    float o = 0.f;
    for (int k = 0; k < cnt; ++k) o += lg[c][k] * bf2f(proj[((size_t)b * SEQ + k) * DIN + C_DV + h * 128 + e]);
    o *= (c == 0 ? inv[0] : inv[1]);
    if (c == 1) o1s[e] = o;
    __syncthreads();
    float v = 0.f;
    if (c == 0) v = o - lam * o1s[e];
    const float ss = block_sum(c == 0 ? v * v : 0.f, red);
    if (c == 0) Y[row * 1024 + 512 + h * 128 + e] = v * rsqrtf(ss * (1.f / 128.f) + LN_EPS) * subg[e] * (1.f - LAMBDA_INIT);
}

__global__ __launch_bounds__(256) void conv_gate_kernel(bf16_t* __restrict__ GU, const float* __restrict__ cw, const float* __restrict__ cb) {
    const int r = blockIdx.x, t = r % SEQ;
    for (int f = threadIdx.x; f < DFF; f += 256) {
        float g = cb[f] + cw[2 * DFF + f] * bf2f(GU[(size_t)r * 5632 + f]);
        if (t >= 1) g += cw[1 * DFF + f] * bf2f(GU[(size_t)(r - 1) * 5632 + f]);
        if (t >= 2) g += cw[0 * DFF + f] * bf2f(GU[(size_t)(r - 2) * 5632 + f]);
        const float u = bf2f(GU[(size_t)r * 5632 + DFF + f]);
        GU[(size_t)r * 5632 + DFF + f] = f2bf(gelu_tanh(g) * u);
    }
}
}

extern "C" void kernel_launch(void* const* d_in, const int* in_sizes, int n_in, void* d_out, int out_size, void* d_ws, size_t ws_size, hipStream_t stream) {
    const float* x = (const float*)d_in[0]; const float* p = (const float*)d_in[1]; const float* w_in = (const float*)d_in[2];
    const float* pe_k = (const float*)d_in[3]; const float* w1_k = (const float*)d_in[4]; const float* w2_k = (const float*)d_in[5];
    const float* pe_v = (const float*)d_in[6]; const float* w1_v = (const float*)d_in[7]; const float* w2_v = (const float*)d_in[8];
    const float* lq1 = (const float*)d_in[9]; const float* lk1 = (const float*)d_in[10]; const float* lq2 = (const float*)d_in[11]; const float* lk2 = (const float*)d_in[12];
    const float* subg = (const float*)d_in[13]; const float* w_bn = (const float*)d_in[14]; const float* w_bd = (const float*)d_in[15]; const float* w_out = (const float*)d_in[16];
    const float* ln1_g = (const float*)d_in[17]; const float* ln1_b = (const float*)d_in[18]; const float* w_ffn_in = (const float*)d_in[19];
    const float* conv_w = (const float*)d_in[20]; const float* conv_b = (const float*)d_in[21]; const float* w_down = (const float*)d_in[22];
    const float* ln2_g = (const float*)d_in[23]; const float* ln2_b = (const float*)d_in[24]; const float* w_pp = (const float*)d_in[25]; const float* w_pg = (const float*)d_in[26];
    const float* table = (const float*)d_in[27];
    float* out = (float*)d_out;
    unsigned char* ws = (unsigned char*)d_ws;
    constexpr size_t MiB = 1u << 20;
    bf16_t* PROJ = (bf16_t*)(ws);
    float* KC = (float*)(ws + 153 * MiB); float* VC = (float*)(ws + 154 * MiB);
    unsigned long long* SEL = (unsigned long long*)(ws + 155 * MiB);
    float* Y = (float*)(ws + 160 * MiB);
    float* OC = (float*)(ws + 224 * MiB);
    float* MERGED = out;
    float* Z1 = (float*)(ws + 160 * MiB);
    float* X1 = (float*)(ws);
    bf16_t* GU = (bf16_t*)(ws + 64 * MiB);
    float* Z2 = out;
    float* X2 = (float*)(ws);
    float* PP = (float*)(ws + 64 * MiB);

    const dim3 blk(256);
    hipLaunchKernelGGL((gemm_naive<float, EpiStoreBf16>), dim3((DIN + 63) / 64, M / 64), blk, 0, stream, x, DM, w_in, DIN, M, DIN, DM, EpiStoreBf16{PROJ, DIN});
    hipLaunchKernelGGL(compress_kernel, dim3(NCMP, 2, BATCH * 2), blk, 0, stream, PROJ, pe_k, w1_k, w2_k, pe_v, w1_v, w2_v, KC, VC);
    hipLaunchKernelGGL(nsa_cmp_kernel, dim3(SEQ, 2, BATCH), blk, 0, stream, PROJ, KC, VC, table, OC, SEL);
    hipLaunchKernelGGL(nsa_slc_win_kernel, dim3(SEQ, 2, BATCH), blk, 0, stream, PROJ, OC, SEL, table, Y);
    hipLaunchKernelGGL(diff_kernel, dim3(SEQ, 4, BATCH), blk, 0, stream, PROJ, table, lq1, lk1, lq2, lk2, subg, Y);
    hipLaunchKernelGGL((gemm_naive<float, EpiGate>), dim3(DM / 64, M / 64), blk, 0, stream, Y, 1024, w_bn, DM, M, DM, 512, EpiGate{MERGED, PROJ, C_GN, 0});
    hipLaunchKernelGGL((gemm_naive<float, EpiGate>), dim3(DM / 64, M / 64), blk, 0, stream, Y + 512, 1024, w_bd, DM, M, DM, 512, EpiGate{MERGED, PROJ, C_GD, 1});
    hipLaunchKernelGGL((gemm_naive<float, EpiResid>), dim3(DM / 64, M / 64), blk, 0, stream, MERGED, DM, w_out, DM, M, DM, DM, EpiResid{Z1, x});
    hipLaunchKernelGGL(ln_rows, dim3(M), blk, 0, stream, Z1, ln1_g, ln1_b, X1);
    hipLaunchKernelGGL((gemm_naive<float, EpiStoreBf16>), dim3(5632 / 64, M / 64), blk, 0, stream, X1, DM, w_ffn_in, 5632, M, 5632, DM, EpiStoreBf16{GU, 5632});
    hipLaunchKernelGGL(conv_gate_kernel, dim3(M), blk, 0, stream, GU, conv_w, conv_b);
    hipLaunchKernelGGL((gemm_naive<bf16_t, EpiResid>), dim3(DM / 64, M / 64), blk, 0, stream, GU + DFF, 5632, w_down, DM, M, DM, DFF, EpiResid{Z2, X1});
    hipLaunchKernelGGL(ln_rows, dim3(M), blk, 0, stream, Z2, ln2_g, ln2_b, X2);
    hipLaunchKernelGGL((gemm_naive<float, EpiStoreF32>), dim3(DM / 64, M / 64), blk, 0, stream, p, DPLE, w_pp, DM, M, DM, DPLE, EpiStoreF32{PP, DM});
    hipLaunchKernelGGL((gemm_naive<float, EpiFinal>), dim3(DM / 64, M / 64), blk, 0, stream, X2, DM, w_pg, DM, M, DM, DM, EpiFinal{out, X2, PP});
}
```
